# Optimizing an MI355X kernel written in HIP

```python
import math
import jax, jax.numpy as jnp
from jax import lax
import numpy as np

D_MODEL = 1024
BATCH = 2
SEQ = 8192
DEPTH = 2

MIX_WIDTH = D_MODEL
DIFF_HEADS = 4
DIFF_QK_DIM = 64
DIFF_V_DIM = 2 * DIFF_QK_DIM
A_QK = DIFF_HEADS * 2 * DIFF_QK_DIM
A_WIDTH = DIFF_HEADS * DIFF_V_DIM
Q_BLOCK = 128
B_WIDTH = MIX_WIDTH - A_WIDTH
CONV_GROUPS = 8
CONV_WIDTH = 3
EVEN_IN = 2 * A_QK + A_WIDTH + 3 * B_WIDTH
EVEN_SPLITS = (A_QK, 2 * A_QK, 2 * A_QK + A_WIDTH,
               2 * A_QK + A_WIDTH + B_WIDTH, 2 * A_QK + A_WIDTH + 2 * B_WIDTH)
CHUNK = 128
SGU_WIDTH = MIX_WIDTH
SGU_GROUPS = 8
SGU_GROUP_DIM = SGU_WIDTH // SGU_GROUPS
ODD_IN = 2 * SGU_WIDTH
REL_BUCKETS = 32
REL_MAX_DIST = 128
FFN_HIDDEN = -(-8 * D_MODEL // (3 * 256)) * 256

N_EVEN = (DEPTH + 1) // 2
N_ODD = DEPTH // 2
RMS_EPS = 1e-6

kernel_name = "hybrid_diffattn_shortconv_sgu_block"


def rms_norm(x, g, eps=RMS_EPS):
    xf = x.astype(jnp.float32)
    y = xf * lax.rsqrt(jnp.mean(xf * xf, axis=-1, keepdims=True) + eps)
    return (y * g.astype(jnp.float32)).astype(x.dtype)


def layer_norm(x, g, b, eps=1e-5):
    xf = x.astype(jnp.float32)
    mu = jnp.mean(xf, axis=-1, keepdims=True)
    xc = xf - mu
    y = xc * lax.rsqrt(jnp.mean(xc * xc, axis=-1, keepdims=True) + eps)
    return (y * g.astype(jnp.float32) + b.astype(jnp.float32)).astype(x.dtype)


def t5_bucket(q_pos, k_pos):
    n = jnp.maximum(q_pos[:, None] - k_pos[None, :], 0)
    max_exact = REL_BUCKETS // 2
    nf = jnp.maximum(n, 1).astype(jnp.float32)
    large = max_exact + (jnp.log(nf / max_exact) / math.log(REL_MAX_DIST / max_exact)
                         * (REL_BUCKETS - max_exact)).astype(jnp.int32)
    large = jnp.minimum(large, REL_BUCKETS - 1)
    return jnp.where(n < max_exact, n, large)


def diff_attention(q, k, v, rel_bias, lam, subln_g, lambda_init):
    bsz, s = q.shape[0], q.shape[1]
    nblk = s // Q_BLOCK
    lam = lam.astype(jnp.float32)
    lam_full = (jnp.exp(jnp.sum(lam[0] * lam[1])) - jnp.exp(jnp.sum(lam[2] * lam[3]))
                + lambda_init)
    scale = DIFF_QK_DIM ** -0.5
    k_pos = jnp.arange(s, dtype=jnp.int32)
    table = rel_bias.astype(jnp.float32)
    qb = q.reshape(bsz, nblk, Q_BLOCK, DIFF_HEADS, 2, DIFF_QK_DIM)
    qb = jnp.moveaxis(qb, 1, 0)
    starts = jnp.arange(nblk, dtype=jnp.int32) * Q_BLOCK

    def block(args):
        q_blk, start = args
        q_pos = start + jnp.arange(Q_BLOCK, dtype=jnp.int32)
        logits = jnp.einsum('bqhmd,bkhmd->bhmqk', q_blk, k).astype(jnp.float32) * scale
        bias = jnp.transpose(table[t5_bucket(q_pos, k_pos)], (2, 0, 1))
        logits = logits + bias[:, None]
        causal = q_pos[:, None] >= k_pos[None, :]
        logits = jnp.where(causal, logits, -jnp.inf)
        p = jax.nn.softmax(logits, axis=-1)
        attn = p[:, :, 0] - lam_full * p[:, :, 1]
        return jnp.einsum('bhqk,bkhe->bqhe', attn.astype(v.dtype), v)

    o = lax.map(block, (qb, starts))
    o = jnp.moveaxis(o, 0, 1).reshape(bsz, s, DIFF_HEADS, DIFF_V_DIM)
    o = rms_norm(o, subln_g, eps=1e-5) * (1.0 - lambda_init)
    return o.reshape(bsz, s, A_WIDTH)


def short_gated_conv(b_gate, c_gate, h, conv_w):
    z = c_gate * h
    y = lax.conv_general_dilated(
        z, conv_w[:, None, :].astype(z.dtype), window_strides=(1,),
        padding=((CONV_WIDTH - 1, 0),), dimension_numbers=('NWC', 'WIO', 'NWC'),
        feature_group_count=z.shape[-1])
    return b_gate * y


def spatial_gating(xn, w_in, ln_g, ln_b, sgu_w, sgu_b, w_out):
    z = jax.nn.gelu(xn @ w_in, approximate=False)
    u, v = jnp.split(z, 2, axis=-1)
    v = layer_norm(v, ln_g, ln_b)
    bsz, s = v.shape[0], v.shape[1]
    vc = v.reshape(bsz, s // CHUNK, CHUNK, SGU_GROUPS, SGU_GROUP_DIM)
    mask = jnp.tril(jnp.ones((CHUNK, CHUNK), dtype=bool))
    ws = jnp.where(mask[None], sgu_w, jnp.zeros_like(sgu_w))
    mixed = jnp.einsum('gts,bnsgc->bntgc', ws.astype(v.dtype), vc)
    mixed = mixed + jnp.transpose(sgu_b)[:, :, None].astype(v.dtype)
    mixed = mixed.reshape(bsz, s, SGU_WIDTH)
    return (u * mixed) @ w_out


def setup_inputs(seed: int = 0) -> dict:
    key = jax.random.key(seed)
    ks = jax.random.split(key, 20)
    n = jax.random.normal
    f32 = jnp.float32
    return {
        "x": n(ks[0], (BATCH, SEQ, D_MODEL), f32),
        "rel_bias": 0.5 * n(ks[1], (REL_BUCKETS, DIFF_HEADS), f32),
        "w_in_even": n(ks[2], (N_EVEN, D_MODEL, EVEN_IN), f32) * D_MODEL ** -0.5,
        "diff_lambda": 0.1 * n(ks[3], (N_EVEN, 4, DIFF_QK_DIM), f32),
        "diff_subln_g": 1.0 + 0.02 * n(ks[4], (N_EVEN, DIFF_V_DIM), f32),
        "conv_w": n(ks[5], (N_EVEN, CONV_WIDTH, B_WIDTH), f32) * CONV_WIDTH ** -0.5,
        "w_out_even": n(ks[6], (N_EVEN, MIX_WIDTH, D_MODEL), f32) * MIX_WIDTH ** -0.5,
        "w_in_odd": n(ks[7], (N_ODD, D_MODEL, ODD_IN), f32) * D_MODEL ** -0.5,
        "sgu_ln_g": 1.0 + 0.02 * n(ks[8], (N_ODD, SGU_WIDTH), f32),
        "sgu_ln_b": 0.02 * n(ks[9], (N_ODD, SGU_WIDTH), f32),
        "sgu_w": n(ks[10], (N_ODD, SGU_GROUPS, CHUNK, CHUNK), f32) * CHUNK ** -0.5,
        "sgu_b": 1.0 + 0.02 * n(ks[11], (N_ODD, SGU_GROUPS, CHUNK), f32),
        "w_out_odd": n(ks[12], (N_ODD, SGU_WIDTH, D_MODEL), f32) * SGU_WIDTH ** -0.5,
        "norm_g": 1.0 + 0.02 * n(ks[13], (DEPTH, 4, D_MODEL), f32),
        "w_gate": n(ks[14], (DEPTH, D_MODEL, FFN_HIDDEN), f32) * D_MODEL ** -0.5,
        "w_up": n(ks[15], (DEPTH, D_MODEL, FFN_HIDDEN), f32) * D_MODEL ** -0.5,
        "w_down": n(ks[16], (DEPTH, FFN_HIDDEN, D_MODEL), f32) * FFN_HIDDEN ** -0.5,
    }


def reference(x, rel_bias, w_in_even, diff_lambda, diff_subln_g, conv_w, w_out_even,
              w_in_odd, sgu_ln_g, sgu_ln_b, sgu_w, sgu_b, w_out_odd, norm_g,
              w_gate, w_up, w_down):
    bsz, s = x.shape[0], x.shape[1]
    for i in range(DEPTH):
        j = i // 2
        h = rms_norm(x, norm_g[i, 0])
        if i % 2 == 0:
            lambda_init = 0.8 - 0.6 * math.exp(-0.3 * i)
            p = h @ w_in_even[j]
            q, k, v, b_gate, c_gate, hc = jnp.split(p, EVEN_SPLITS, axis=-1)
            q = q.reshape(bsz, s, DIFF_HEADS, 2, DIFF_QK_DIM)
            k = k.reshape(bsz, s, DIFF_HEADS, 2, DIFF_QK_DIM)
            v = v.reshape(bsz, s, DIFF_HEADS, DIFF_V_DIM)
            a_out = diff_attention(q, k, v, rel_bias, diff_lambda[j], diff_subln_g[j],
                                   lambda_init)
            b_out = short_gated_conv(b_gate, c_gate, hc, conv_w[j])
            mix = jnp.concatenate([a_out, b_out], axis=-1) @ w_out_even[j]
        else:
            mix = spatial_gating(h, w_in_odd[j], sgu_ln_g[j], sgu_ln_b[j], sgu_w[j],
                                 sgu_b[j], w_out_odd[j])
        x = x + rms_norm(mix, norm_g[i, 1])
        h = rms_norm(x, norm_g[i, 2])
        f = (jax.nn.silu(h @ w_gate[i]) * (h @ w_up[i])) @ w_down[i]
        x = x + rms_norm(f, norm_g[i, 3])
    return x
```

```cpp
#include <hip/hip_runtime.h>
#include <cstdio>
#include <cstdint>
#include <cmath>

namespace nv {
constexpr int BATCH = 2, SEQ = 8192, DM = 1024, M = BATCH * SEQ;
constexpr int EVEN_IN = 3072, FFN = 2816, ODD_IN = 2048, NH = 4;

__device__ __forceinline__ float wave_sum(float v) {
#pragma unroll
    for (int o = 1; o < 64; o <<= 1) v += __shfl_xor(v, o);
    return v;
}
__device__ __forceinline__ float block_sum256(float v, float* red) {
    v = wave_sum(v);
    const int w = threadIdx.x >> 6;
    __syncthreads();
    if ((threadIdx.x & 63) == 0) red[w] = v;
    __syncthreads();
    return red[0] + red[1] + red[2] + red[3];
}
__global__ __launch_bounds__(256) void k_rmsnorm(const float* x, int ldx, const float* g, const float* add, float* out, float eps) {
    __shared__ float red[4];
    const int row = blockIdx.x, t = threadIdx.x;
    const float4 v = *(const float4*)(x + (size_t)row * ldx + 4 * t);
    const float ss = block_sum256(v.x * v.x + v.y * v.y + v.z * v.z + v.w * v.w, red);
    const float r = rsqrtf(ss * (1.0f / 1024.0f) + eps);
    const float4 gg = *(const float4*)(g + 4 * t);
    float4 o = make_float4(v.x * r * gg.x, v.y * r * gg.y, v.z * r * gg.z, v.w * r * gg.w);
    if (add) { const float4 a = *(const float4*)(add + (size_t)row * 1024 + 4 * t); o.x += a.x; o.y += a.y; o.z += a.z; o.w += a.w; }
    *(float4*)(out + (size_t)row * 1024 + 4 * t) = o;
}
__global__ __launch_bounds__(256) void k_layernorm(float* x, int ldx, const float* g, const float* b, float eps) {
    __shared__ float red[4];
    const int row = blockIdx.x, t = threadIdx.x;
    float4 v = *(const float4*)(x + (size_t)row * ldx + 4 * t);
    const float mu = block_sum256(v.x + v.y + v.z + v.w, red) * (1.0f / 1024.0f);
    v.x -= mu; v.y -= mu; v.z -= mu; v.w -= mu;
    const float var = block_sum256(v.x * v.x + v.y * v.y + v.z * v.z + v.w * v.w, red) * (1.0f / 1024.0f);
    const float r = rsqrtf(var + eps);
    const float4 gg = *(const float4*)(g + 4 * t), bb = *(const float4*)(b + 4 * t);
    *(float4*)(x + (size_t)row * ldx + 4 * t) = make_float4(v.x * r * gg.x + bb.x, v.y * r * gg.y + bb.y, v.z * r * gg.z + bb.z, v.w * r * gg.w + bb.w);
}

template <int MODE>
__global__ __launch_bounds__(256) void k_gemm(const float* A, int lda, const float* W, const float* W2, int ldw, float* C, int ldc, int K) {
    __shared__ float As[16][68];
    __shared__ float Bs[16][64];
    __shared__ float Bs2[MODE == 1 ? 16 : 1][64];
    const int tid = threadIdx.x, tx = tid & 15, ty = tid >> 4;
    const int m0 = blockIdx.y * 64, n0 = blockIdx.x * 64;
    float acc[4][4], acc2[4][4];
#pragma unroll
    for (int i = 0; i < 4; ++i)
#pragma unroll
        for (int j = 0; j < 4; ++j) { acc[i][j] = 0.f; acc2[i][j] = 0.f; }
    const int arow = tid >> 2, akq = (tid & 3) * 4, bk = tid >> 4, bn = (tid & 15) * 4;
    for (int k0 = 0; k0 < K; k0 += 16) {
        const float4 a = *(const float4*)(A + (size_t)(m0 + arow) * lda + k0 + akq);
        const float4 b = *(const float4*)(W + (size_t)(k0 + bk) * ldw + n0 + bn);
        float4 b2 = make_float4(0, 0, 0, 0);
        if (MODE == 1) b2 = *(const float4*)(W2 + (size_t)(k0 + bk) * ldw + n0 + bn);
        __syncthreads();
        As[akq + 0][arow] = a.x; As[akq + 1][arow] = a.y; As[akq + 2][arow] = a.z; As[akq + 3][arow] = a.w;
        *(float4*)&Bs[bk][bn] = b;
        if (MODE == 1) *(float4*)&Bs2[bk][bn] = b2;
        __syncthreads();
#pragma unroll
        for (int kk = 0; kk < 16; ++kk) {
            const float4 av = *(const float4*)&As[kk][ty * 4];
            const float4 bv = *(const float4*)&Bs[kk][tx * 4];
            const float aa[4] = {av.x, av.y, av.z, av.w}, bb[4] = {bv.x, bv.y, bv.z, bv.w};
#pragma unroll
            for (int i = 0; i < 4; ++i)
#pragma unroll
                for (int j = 0; j < 4; ++j) acc[i][j] += aa[i] * bb[j];
            if (MODE == 1) {
                const float4 cv = *(const float4*)&Bs2[kk][tx * 4];
                const float cc[4] = {cv.x, cv.y, cv.z, cv.w};
#pragma unroll
                for (int i = 0; i < 4; ++i)
#pragma unroll
                    for (int j = 0; j < 4; ++j) acc2[i][j] += aa[i] * cc[j];
            }
        }
    }
#pragma unroll
    for (int i = 0; i < 4; ++i) {
        float o[4];
#pragma unroll
        for (int j = 0; j < 4; ++j) {
            float v = acc[i][j];
            if (MODE == 1) v = (v / (1.0f + expf(-v))) * acc2[i][j];
            if (MODE == 2) v = 0.5f * v * (1.0f + erff(v * 0.70710678118654752f));
            o[j] = v;
        }
        *(float4*)(C + (size_t)(m0 + ty * 4 + i) * ldc + n0 + tx * 4) = make_float4(o[0], o[1], o[2], o[3]);
    }
}

__device__ __forceinline__ int t5_bucket(int n) {
    if (n < 16) return n;
    int b = 16;
    const int th[15] = {19, 21, 24, 27, 31, 35, 40, 46, 52, 59, 67, 77, 87, 99, 113};
#pragma unroll
    for (int i = 0; i < 15; ++i) b += (n >= th[i]) ? 1 : 0;
    return b;
}

__global__ __launch_bounds__(256) void k_attn_stats(const float* P, int ldp, const float* rel_bias, float* stats) {
    __shared__ float Ks[32][68];
    __shared__ float lut[128];
    const int tid = threadIdx.x, row = tid >> 2, part = tid & 3;
    const int qb = blockIdx.x, bhm = blockIdx.y, mp = bhm & 1, h = (bhm >> 1) & 3, b = bhm >> 3;
    const int q0 = qb * 64, q = q0 + row;
    if (tid < 128) lut[tid] = rel_bias[t5_bucket(tid) * NH + h];
    const float* Pb = P + (size_t)b * SEQ * ldp;
    float qv[64];
    {
        const float* qp = Pb + (size_t)q * ldp + h * 128 + mp * 64;
#pragma unroll
        for (int d = 0; d < 64; d += 4) { const float4 v = *(const float4*)(qp + d); qv[d] = v.x; qv[d + 1] = v.y; qv[d + 2] = v.z; qv[d + 3] = v.w; }
    }
    float m = -INFINITY, l = 0.f;
    const int nt = (q0 + 64) / 32;
    for (int kt = 0; kt < nt; ++kt) {
        __syncthreads();
        {
#pragma unroll
            for (int i = 0; i < 2; ++i) { const int idx = tid + 256 * i, kr = idx >> 4, kc = (idx & 15) * 4;
                *(float4*)&Ks[kr][kc] = *(const float4*)(Pb + (size_t)(kt * 32 + kr) * ldp + 512 + h * 128 + mp * 64 + kc); }
        }
        __syncthreads();
#pragma unroll
        for (int i = 0; i < 8; ++i) {
            const int kk = part + 4 * i, k = kt * 32 + kk;
            float s = 0.f;
#pragma unroll
            for (int d = 0; d < 64; d += 4) { const float4 kv = *(const float4*)&Ks[kk][d]; s += qv[d] * kv.x + qv[d + 1] * kv.y + qv[d + 2] * kv.z + qv[d + 3] * kv.w; }
            if (k <= q) {
                const int n = q - k;
                s = s * 0.125f + lut[n < 127 ? n : 127];
                const float mn = fmaxf(m, s);
                l = l * expf(m - mn) + expf(s - mn);
                m = mn;
            }
        }
    }
    float mm = m;
    mm = fmaxf(mm, __shfl_xor(mm, 1)); mm = fmaxf(mm, __shfl_xor(mm, 2));
    float lc = (m == -INFINITY) ? 0.f : l * expf(m - mm);
    lc += __shfl_xor(lc, 1); lc += __shfl_xor(lc, 2);
    if (part == 0) { float* st = stats + ((size_t)(b * NH + h) * 2 + mp) * SEQ * 2 + (size_t)q * 2; st[0] = mm; st[1] = lc; }
}

__global__ __launch_bounds__(256) void k_attn_out(const float* P, int ldp, const float* rel_bias, const float* stats, const float* dl, const float* subg, float* A2) {
    __shared__ float Ks[32][68];
    __shared__ float Vs[32][128];
    __shared__ float Ps[64][33];
    __shared__ float lut[128];
    __shared__ float lam_s;
    const int tid = threadIdx.x, row = tid >> 2, part = tid & 3;
    const int qb = blockIdx.x, bh = blockIdx.y, h = bh & 3, b = bh >> 2;
    const int q0 = qb * 64, q = q0 + row;
    if (tid < 128) lut[tid] = rel_bias[t5_bucket(tid) * NH + h];
    if (tid == 0) { float s1 = 0.f, s2 = 0.f; for (int d = 0; d < 64; ++d) { s1 += dl[d] * dl[64 + d]; s2 += dl[128 + d] * dl[192 + d]; } lam_s = expf(s1) - expf(s2) + 0.2f; }
    const float* Pb = P + (size_t)b * SEQ * ldp;
    float m0, l0, m1, l1;
    { const float* st = stats + ((size_t)(b * NH + h) * 2) * SEQ * 2 + (size_t)q * 2; m0 = st[0]; l0 = st[1]; m1 = st[SEQ * 2]; l1 = st[SEQ * 2 + 1]; }
    float o[32];
#pragma unroll
    for (int d = 0; d < 32; ++d) o[d] = 0.f;
    __syncthreads();
    const float lam = lam_s;
    const int nt = (q0 + 64) / 32;
    for (int kt = 0; kt < nt; ++kt) {
        float pr[8];
#pragma unroll
        for (int mp = 0; mp < 2; ++mp) {
            __syncthreads();
#pragma unroll
            for (int i = 0; i < 2; ++i) { const int idx = tid + 256 * i, kr = idx >> 4, kc = (idx & 15) * 4;
                *(float4*)&Ks[kr][kc] = *(const float4*)(Pb + (size_t)(kt * 32 + kr) * ldp + 512 + h * 128 + mp * 64 + kc); }
            if (mp == 0) {
#pragma unroll
                for (int i = 0; i < 4; ++i) { const int idx = tid + 256 * i, kr = idx >> 5, kc = (idx & 31) * 4;
                    *(float4*)&Vs[kr][kc] = *(const float4*)(Pb + (size_t)(kt * 32 + kr) * ldp + 1024 + h * 128 + kc); }
            }
            __syncthreads();
            const float* qp = Pb + (size_t)q * ldp + h * 128 + mp * 64;
            float sc[8];
#pragma unroll
            for (int i = 0; i < 8; ++i) sc[i] = 0.f;
#pragma unroll 2
            for (int d = 0; d < 64; d += 4) {
                const float4 qv = *(const float4*)(qp + d);
#pragma unroll
                for (int i = 0; i < 8; ++i) { const float4 kv = *(const float4*)&Ks[part + 4 * i][d]; sc[i] += qv.x * kv.x + qv.y * kv.y + qv.z * kv.z + qv.w * kv.w; }
            }
#pragma unroll
            for (int i = 0; i < 8; ++i) {
                const int k = kt * 32 + part + 4 * i;
                float p = 0.f;
                if (k <= q) { const int n = q - k; const float s = sc[i] * 0.125f + lut[n < 127 ? n : 127]; p = (mp == 0) ? expf(s - m0) / l0 : expf(s - m1) / l1; }
                pr[i] = (mp == 0) ? p : pr[i] - lam * p;
            }
        }
#pragma unroll
        for (int i = 0; i < 8; ++i) Ps[row][part + 4 * i] = pr[i];
        __syncthreads();
#pragma unroll 2
        for (int kk = 0; kk < 32; ++kk) {
            const float p = Ps[row][kk];
#pragma unroll
            for (int d = 0; d < 32; d += 4) { const float4 vv = *(const float4*)&Vs[kk][part * 32 + d]; o[d] += p * vv.x; o[d + 1] += p * vv.y; o[d + 2] += p * vv.z; o[d + 3] += p * vv.w; }
        }
    }
    float ss = 0.f;
#pragma unroll
    for (int d = 0; d < 32; ++d) ss += o[d] * o[d];
    ss += __shfl_xor(ss, 1); ss += __shfl_xor(ss, 2);
    const float r = rsqrtf(ss * (1.0f / 128.0f) + 1e-5f) * 0.8f;
    float* op = A2 + (size_t)(b * SEQ + q) * 1024 + h * 128 + part * 32;
#pragma unroll
    for (int d = 0; d < 32; ++d) op[d] = o[d] * r * subg[part * 32 + d];
}

__global__ __launch_bounds__(256) void k_conv(const float* G, const float* cw, float* A2) {
    const size_t idx = (size_t)blockIdx.x * 256 + threadIdx.x;
    const int c = idx & 511; const size_t row = idx >> 9; const int t = (int)(row % SEQ);
    const float* g = G + row * 1536;
    float y = cw[2 * 512 + c] * (g[512 + c] * g[1024 + c]);
    if (t >= 1) y += cw[1 * 512 + c] * (g[512 + c - 1536] * g[1024 + c - 1536]);
    if (t >= 2) y += cw[0 * 512 + c] * (g[512 + c - 3072] * g[1024 + c - 3072]);
    A2[row * 1024 + 512 + c] = g[c] * y;
}

__global__ __launch_bounds__(256) void k_sgu(const float* Z, const float* sw, const float* sb, float* A3) {
    __shared__ float Vs[32][128];
    __shared__ float Ws[128][33];
    const int tid = threadIdx.x, c = tid & 127, th = tid >> 7;
    const int chunk = blockIdx.x, g = blockIdx.y;
    const size_t r0 = (size_t)chunk * 128;
    float acc[64];
#pragma unroll
    for (int i = 0; i < 64; ++i) acc[i] = 0.f;
    for (int s0 = 0; s0 < 128; s0 += 32) {
        __syncthreads();
        for (int i = tid; i < 32 * 128; i += 256) { const int s = i >> 7, cc = i & 127; Vs[s][cc] = Z[(r0 + s0 + s) * 2048 + 1024 + g * 128 + cc]; }
        for (int i = tid; i < 128 * 32; i += 256) { const int t = i >> 5, s = i & 31; Ws[t][s] = (s0 + s <= t) ? sw[((size_t)g * 128 + t) * 128 + s0 + s] : 0.f; }
        __syncthreads();
        for (int s = 0; s < 32; ++s) {
            const float vv = Vs[s][c];
#pragma unroll
            for (int i = 0; i < 64; ++i) acc[i] += Ws[th * 64 + i][s] * vv;
        }
    }
#pragma unroll
    for (int i = 0; i < 64; ++i) {
        const int t = th * 64 + i;
        const float u = Z[(r0 + t) * 2048 + g * 128 + c];
        A3[(r0 + t) * 1024 + g * 128 + c] = u * (acc[i] + sb[g * 128 + t]);
    }
}
}

extern "C" void kernel_launch(void* const* d_in, const int* in_sizes, int n_in, void* d_out, int out_size, void* d_ws, size_t ws_size, hipStream_t stream) {
    using namespace nv;
    const float* x = (const float*)d_in[0]; const float* rel_bias = (const float*)d_in[1]; const float* w_in_even = (const float*)d_in[2];
    const float* diff_lambda = (const float*)d_in[3]; const float* subln_g = (const float*)d_in[4]; const float* conv_w = (const float*)d_in[5];
    const float* w_out_even = (const float*)d_in[6]; const float* w_in_odd = (const float*)d_in[7]; const float* ln_g = (const float*)d_in[8];
    const float* ln_b = (const float*)d_in[9]; const float* sgu_w = (const float*)d_in[10]; const float* sgu_b = (const float*)d_in[11];
    const float* w_out_odd = (const float*)d_in[12]; const float* norm_g = (const float*)d_in[13]; const float* w_gate = (const float*)d_in[14];
    const float* w_up = (const float*)d_in[15]; const float* w_down = (const float*)d_in[16];
    float* X = (float*)d_out;
    char* ws = (char*)d_ws; const size_t MiB = 1u << 20;
    float* R0 = (float*)(ws);
    float* R1 = (float*)(ws + 64 * MiB);
    float* R2 = (float*)(ws + 160 * MiB);
    float* ST = (float*)(ws + 224 * MiB);
    float* R3 = (float*)(ws + 192 * MiB);
    const dim3 blk(256);
    k_rmsnorm<<<M, blk, 0, stream>>>(x, 1024, norm_g + 0 * 1024, nullptr, R0, 1e-6f);
    k_gemm<0><<<dim3(1536 / 64, M / 64), blk, 0, stream>>>(R0, 1024, w_in_even, nullptr, EVEN_IN, R1, 1536, 1024);
    k_attn_stats<<<dim3(SEQ / 64, BATCH * NH * 2), blk, 0, stream>>>(R1, 1536, rel_bias, ST);
    k_attn_out<<<dim3(SEQ / 64, BATCH * NH), blk, 0, stream>>>(R1, 1536, rel_bias, ST, diff_lambda, subln_g, R2);
    k_gemm<0><<<dim3(1536 / 64, M / 64), blk, 0, stream>>>(R0, 1024, w_in_even + 1536, nullptr, EVEN_IN, R1, 1536, 1024);
    k_conv<<<M * 512 / 256, blk, 0, stream>>>(R1, conv_w, R2);
    k_gemm<0><<<dim3(1024 / 64, M / 64), blk, 0, stream>>>(R2, 1024, w_out_even, nullptr, 1024, R0, 1024, 1024);
    k_rmsnorm<<<M, blk, 0, stream>>>(R0, 1024, norm_g + 1 * 1024, x, X, 1e-6f);
    for (int layer = 0; layer < 2; ++layer) {
        if (layer == 1) {
            k_rmsnorm<<<M, blk, 0, stream>>>(X, 1024, norm_g + 4 * 1024, nullptr, R0, 1e-6f);
            k_gemm<2><<<dim3(2048 / 64, M / 64), blk, 0, stream>>>(R0, 1024, w_in_odd, nullptr, ODD_IN, R1, 2048, 1024);
            k_layernorm<<<M, blk, 0, stream>>>(R1 + 1024, 2048, ln_g, ln_b, 1e-5f);
            k_sgu<<<dim3(M / 128, 8), blk, 0, stream>>>(R1, sgu_w, sgu_b, R3);
            k_gemm<0><<<dim3(1024 / 64, M / 64), blk, 0, stream>>>(R3, 1024, w_out_odd, nullptr, 1024, R0, 1024, 1024);
            k_rmsnorm<<<M, blk, 0, stream>>>(R0, 1024, norm_g + 5 * 1024, X, X, 1e-6f);
        }
        const float* ng = norm_g + (size_t)layer * 4 * 1024;
        k_rmsnorm<<<M, blk, 0, stream>>>(X, 1024, ng + 2 * 1024, nullptr, R0, 1e-6f);
        k_gemm<1><<<dim3(FFN / 64, M / 64), blk, 0, stream>>>(R0, 1024, w_gate + (size_t)layer * 1024 * FFN, w_up + (size_t)layer * 1024 * FFN, FFN, R1, FFN, 1024);
        k_gemm<0><<<dim3(1024 / 64, M / 64), blk, 0, stream>>>(R1, FFN, w_down + (size_t)layer * FFN * 1024, nullptr, 1024, R0, 1024, FFN);
        k_rmsnorm<<<M, blk, 0, stream>>>(R0, 1024, ng + 3 * 1024, X, X, 1e-6f);
    }
}
```
